# Optimizing an MI355X kernel written in HIP

```python
import math
import jax, jax.numpy as jnp
from jax import lax
import numpy as np

D_MODEL = 2048
BATCH = 4
SEQ = 4096
DEPTH = 1

GRID_W = 64
CTX_LEN = 256
D_MIX = D_MODEL
GLA_HEADS = 4
GLA_DK = (D_MIX // 4) // GLA_HEADS
GLA_DV = (D_MIX // 2) // GLA_HEADS
GLA_RANK = 16
GLA_TAU = 16.0
GLA_CHUNK = 64
DIFF_HEADS = 8
DIFF_DH = 64
DIFF_DV = 2 * DIFF_DH
ROPE_BASE = 10000.0
Q_BLOCK = 128
N_EXPERTS = 16
EC_CAPACITY_FACTOR = 2
D_FF_EXPERT = D_MODEL
ALPHA = (2.0 * DEPTH) ** 0.25
BETA = (8.0 * DEPTH) ** -0.25
LN_EPS = 1e-5
RMS_EPS = 1e-6

IN_SIZES = (GLA_HEADS * GLA_DK, GLA_HEADS * GLA_DK, GLA_HEADS * GLA_DV, GLA_HEADS * GLA_DV, 2 * GLA_RANK,
            DIFF_HEADS * 2 * DIFF_DH, DIFF_HEADS * 2 * DIFF_DH, DIFF_HEADS * DIFF_DV)
IN_SPLITS = tuple(int(s) for s in np.cumsum(IN_SIZES)[:-1])
D_IN = int(sum(IN_SIZES))

kernel_name = 'hybrid_gla_diffattn_ec_moe_diffusion_block'


def layer_norm(x, g, b):
    xf = x.astype(jnp.float32)
    mu = jnp.mean(xf, axis=-1, keepdims=True)
    var = jnp.mean(jnp.square(xf - mu), axis=-1, keepdims=True)
    return ((xf - mu) * lax.rsqrt(var + LN_EPS) * g + b).astype(x.dtype)


def head_rms_norm(x, g):
    xf = x.astype(jnp.float32)
    return (xf * lax.rsqrt(jnp.mean(xf * xf, axis=-1, keepdims=True) + RMS_EPS) * g).astype(x.dtype)


def axial_rope_tables(rows, dh):
    row = jnp.repeat(jnp.arange(rows, dtype=jnp.float32), GRID_W)
    col = jnp.tile(jnp.arange(GRID_W, dtype=jnp.float32), rows)
    n_freq = dh // 4
    inv = ROPE_BASE ** (-jnp.arange(n_freq, dtype=jnp.float32) / n_freq)
    ang = jnp.concatenate([row[:, None] * inv, col[:, None] * inv], axis=-1)
    return jnp.cos(ang), jnp.sin(ang)


def apply_rope(x, cos, sin):
    half = x.shape[-1] // 2
    xf = x.astype(jnp.float32)
    x1, x2 = xf[..., :half], xf[..., half:]
    cs = cos[None, :, None, None, :]
    sn = sin[None, :, None, None, :]
    return jnp.concatenate([x1 * cs - x2 * sn, x1 * sn + x2 * cs], axis=-1).astype(x.dtype)


def flip(a):
    return a[:, :, ::-1]


def gla_inputs(gq, gk, gv, glr, w_gate2, b_gate):
    B, N, _ = gq.shape
    heads = lambda a: a.reshape(B, N, GLA_HEADS, -1).transpose(0, 2, 1, 3).astype(jnp.float32)
    q = heads(gq) * (GLA_DK ** -0.5)
    k = heads(gk)
    v = heads(gv)
    logg = [jax.nn.log_sigmoid(heads(glr[..., d * GLA_RANK:(d + 1) * GLA_RANK] @ w_gate2[d] + b_gate[d])) / GLA_TAU
            for d in range(2)]
    return q, k, v, logg[0], logg[1]


def gla_chunk_scan(q, k, v, logg, s0):
    B, H, N, dk = q.shape
    dv = v.shape[-1]
    nc = N // GLA_CHUNK
    split = lambda a: a.reshape(B, H, nc, GLA_CHUNK, a.shape[-1]).transpose(2, 0, 1, 3, 4)
    mask = jnp.tril(jnp.ones((GLA_CHUNK, GLA_CHUNK), dtype=bool))

    def step(s, inp):
        qb, kb, vb, gb = inp
        bcum = jnp.cumsum(gb, axis=-2)
        btot = bcum[..., -1:, :]
        q_in = qb * jnp.exp(bcum)
        k_in = kb * jnp.exp(-bcum)
        k_out = kb * jnp.exp(btot - bcum)
        att = jnp.where(mask, jnp.einsum('bhik,bhjk->bhij', q_in, k_in), 0.0)
        o = jnp.einsum('bhij,bhjv->bhiv', att, vb) + jnp.einsum('bhik,bhkv->bhiv', q_in, s)
        s_new = jnp.exp(btot)[..., 0, :, None] * s + jnp.einsum('bhjk,bhjv->bhkv', k_out, vb)
        return s_new, o

    s_fin, oc = lax.scan(step, s0, (split(q), split(k), split(v), split(logg)))
    return oc.transpose(1, 2, 0, 3, 4).reshape(B, H, N, dv), s_fin


def gla_output(o, r, g):
    B, H, N, dv = o.shape
    o = head_rms_norm(o, g).transpose(0, 2, 1, 3).reshape(B, N, H * dv)
    return o.astype(r.dtype) * jax.nn.silu(r)


def diff_heads(dq, dk, dv):
    B, N, _ = dq.shape
    return (dq.reshape(B, N, DIFF_HEADS, 2, DIFF_DH), dk.reshape(B, N, DIFF_HEADS, 2, DIFF_DH),
            dv.reshape(B, N, DIFF_HEADS, DIFF_DV))


def diff_attend(q, k, v, lam):
    s = jnp.einsum('bqhmd,bkhmd->bhmqk', q, k).astype(jnp.float32) * (DIFF_DH ** -0.5)
    p = jax.nn.softmax(s, axis=-1)
    a = p[:, :, 0] - lam * p[:, :, 1]
    return jnp.einsum('bhqk,bkhv->bqhv', a.astype(v.dtype), v)


def diff_output(o, g, lam_init):
    B, N, H, dv = o.shape
    return (head_rms_norm(o, g) * (1.0 - lam_init)).reshape(B, N, H * dv)


def hybrid_mixer(u_ctx, u_lat, cos, sin, w_in, w_gate2, b_gate, gla_norm_g, diff_lambda, diff_norm_g, w_o,
                 lam_init, need_ctx_out):
    gq_c, gk_c, gv_c, gr_c, glr_c, dq_c, dk_c, dv_c = jnp.split(u_ctx @ w_in, IN_SPLITS, axis=-1)
    gq_l, gk_l, gv_l, gr_l, glr_l, dq_l, dk_l, dv_l = jnp.split(u_lat @ w_in, IN_SPLITS, axis=-1)
    B, n, _ = u_lat.shape

    qc, kc, vc, gfc, gbc = gla_inputs(gq_c, gk_c, gv_c, glr_c, w_gate2, b_gate)
    ql, kl, vl, gfl, gbl = gla_inputs(gq_l, gk_l, gv_l, glr_l, w_gate2, b_gate)
    s0 = jnp.zeros((B, GLA_HEADS, GLA_DK, GLA_DV), jnp.float32)
    o_cf, s_cf = gla_chunk_scan(qc, kc, vc, gfc, s0)
    o_cb, s_cb = gla_chunk_scan(flip(qc), flip(kc), flip(vc), flip(gbc), s0)
    o_lf, _ = gla_chunk_scan(ql, kl, vl, gfl, s_cf)
    o_lb, _ = gla_chunk_scan(flip(ql), flip(kl), flip(vl), flip(gbl), s_cb)
    gla_lat = gla_output(o_lf + flip(o_lb), gr_l, gla_norm_g)

    lq1, lk1, lq2, lk2 = diff_lambda.astype(jnp.float32)
    lam = jnp.exp(jnp.sum(lq1 * lk1)) - jnp.exp(jnp.sum(lq2 * lk2)) + lam_init
    qc_d, kc_d, vc_d = diff_heads(dq_c, dk_c, dv_c)
    ql_d, kl_d, vl_d = diff_heads(dq_l, dk_l, dv_l)
    ql_d = apply_rope(ql_d, cos, sin)
    kl_d = apply_rope(kl_d, cos, sin)
    k_all = jnp.concatenate([kc_d, kl_d], axis=1)
    v_all = jnp.concatenate([vc_d, vl_d], axis=1)
    nblk = n // Q_BLOCK
    qb = ql_d.reshape(B, nblk, Q_BLOCK, DIFF_HEADS, 2, DIFF_DH).swapaxes(0, 1)
    ob = lax.map(lambda qblk: diff_attend(qblk, k_all, v_all, lam), qb)
    diff_lat = diff_output(ob.swapaxes(0, 1).reshape(B, n, DIFF_HEADS, DIFF_DV), diff_norm_g, lam_init)

    out_lat = jnp.concatenate([gla_lat, diff_lat], axis=-1) @ w_o
    if not need_ctx_out:
        return None, out_lat
    gla_ctx = gla_output(o_cf + flip(o_cb), gr_c, gla_norm_g)
    diff_ctx = diff_output(diff_attend(qc_d, kc_d, vc_d, lam), diff_norm_g, lam_init)
    out_ctx = jnp.concatenate([gla_ctx, diff_ctx], axis=-1) @ w_o
    return out_ctx, out_lat


def expert_choice_ffn(h, w_router, w1, w3, w2):
    B, N, D = h.shape
    cap = EC_CAPACITY_FACTOR * N // N_EXPERTS
    aff = jax.nn.softmax((h @ w_router).astype(jnp.float32), axis=-1)
    gate, idx = lax.top_k(aff.swapaxes(1, 2), cap)
    xs = jax.vmap(lambda hb, ib: hb[ib])(h, idx)
    hid = jax.nn.silu(jnp.einsum('becd,edf->becf', xs, w1)) * jnp.einsum('becd,edf->becf', xs, w3)
    y = jnp.einsum('becf,efd->becd', hid, w2) * gate[..., None].astype(h.dtype)
    flat = (idx + (jnp.arange(B, dtype=idx.dtype) * N)[:, None, None]).reshape(-1)
    out = jax.ops.segment_sum(y.reshape(-1, D), flat, num_segments=B * N)
    return out.reshape(B, N, D)


def setup_inputs(seed: int = 0) -> dict:
    key = jax.random.key(seed)
    ks = jax.random.split(key, 24)
    nrm = lambda k, shape, s: jax.random.normal(k, shape, jnp.float32) * s
    col_scale = np.ones((D_IN,), np.float32)
    col_scale[IN_SPLITS[1]:IN_SPLITS[2]] = BETA
    col_scale[IN_SPLITS[6]:] = BETA
    return {
        'x': nrm(ks[0], (BATCH, SEQ, D_MODEL), 1.0),
        'c': nrm(ks[1], (BATCH, D_MODEL), 1.0),
        'ctx': nrm(ks[2], (BATCH, CTX_LEN, D_MODEL), 1.0),
        'c_ctx': nrm(ks[3], (D_MODEL,), 1.0),
        'w_ada': nrm(ks[4], (DEPTH, D_MODEL, 6 * D_MODEL), 0.5 * D_MODEL ** -0.5),
        'b_ada': nrm(ks[5], (DEPTH, 6 * D_MODEL), 0.01),
        'w_in': nrm(ks[6], (DEPTH, D_MODEL, D_IN), D_MODEL ** -0.5) * jnp.asarray(col_scale),
        'w_gate2': nrm(ks[7], (DEPTH, 2, GLA_RANK, GLA_HEADS * GLA_DK), GLA_RANK ** -0.5),
        'b_gate': nrm(ks[8], (DEPTH, 2, GLA_HEADS * GLA_DK), 0.1),
        'gla_norm_g': 1.0 + nrm(ks[9], (DEPTH, GLA_DV), 0.02),
        'diff_lambda': nrm(ks[10], (DEPTH, 4, DIFF_DH), 0.1),
        'diff_norm_g': 1.0 + nrm(ks[11], (DEPTH, DIFF_DV), 0.02),
        'w_o': nrm(ks[12], (DEPTH, D_MIX, D_MODEL), BETA * D_MIX ** -0.5),
        'ln1_g': 1.0 + nrm(ks[13], (DEPTH, D_MODEL), 0.02),
        'ln1_b': nrm(ks[14], (DEPTH, D_MODEL), 0.01),
        'w_router': nrm(ks[15], (DEPTH, D_MODEL, N_EXPERTS), D_MODEL ** -0.5),
        'w1': nrm(ks[16], (DEPTH, N_EXPERTS, D_MODEL, D_FF_EXPERT), D_MODEL ** -0.5),
        'w3': nrm(ks[17], (DEPTH, N_EXPERTS, D_MODEL, D_FF_EXPERT), D_MODEL ** -0.5),
        'w2': nrm(ks[18], (DEPTH, N_EXPERTS, D_FF_EXPERT, D_MODEL), BETA * D_FF_EXPERT ** -0.5),
        'ln2_g': 1.0 + nrm(ks[19], (DEPTH, D_MODEL), 0.02),
        'ln2_b': nrm(ks[20], (DEPTH, D_MODEL), 0.01),
    }


def reference(x, c, ctx, c_ctx, w_ada, b_ada, w_in, w_gate2, b_gate, gla_norm_g, diff_lambda, diff_norm_g,
              w_o, ln1_g, ln1_b, w_router, w1, w3, w2, ln2_g, ln2_b):
    n_lat = x.shape[1]
    rows = n_lat // GRID_W
    cos, sin = axial_rope_tables(rows, DIFF_DH)
    for l in range(DEPTH):
        last = l == DEPTH - 1
        lam_init = 0.8 - 0.6 * math.exp(-0.3 * l)
        mod_l = jax.nn.silu(c) @ w_ada[l] + b_ada[l]
        mod_c = jax.nn.silu(c_ctx) @ w_ada[l] + b_ada[l]
        sh1, sc1, g1, sh2, sc2, g2 = jnp.split(mod_l[:, None, :], 6, axis=-1)
        csh1, csc1, cg1, csh2, csc2, cg2 = jnp.split(mod_c, 6, axis=-1)
        o_ctx, o_lat = hybrid_mixer(ctx * (1.0 + csc1) + csh1, x * (1.0 + sc1) + sh1, cos, sin, w_in[l],
                                    w_gate2[l], b_gate[l], gla_norm_g[l], diff_lambda[l], diff_norm_g[l],
                                    w_o[l], lam_init, not last)
        x = layer_norm(ALPHA * x + g1 * o_lat, ln1_g[l], ln1_b[l])
        f_lat = expert_choice_ffn(x * (1.0 + sc2) + sh2, w_router[l], w1[l], w3[l], w2[l])
        x = layer_norm(ALPHA * x + g2 * f_lat, ln2_g[l], ln2_b[l])
        if not last:
            ctx = layer_norm(ALPHA * ctx + cg1 * o_ctx, ln1_g[l], ln1_b[l])
            f_ctx = expert_choice_ffn(ctx * (1.0 + csc2) + csh2, w_router[l], w1[l], w3[l], w2[l])
            ctx = layer_norm(ALPHA * ctx + cg2 * f_ctx, ln2_g[l], ln2_b[l])
    return x
```

```cpp
#include <hip/hip_runtime.h>
#include <cstdio>
#include <cstdint>

#ifndef MK_ONE_LAUNCH
#define MK_ONE_LAUNCH 0
#endif

#define LAS __attribute__((address_space(3)))
typedef unsigned short bf16_t;
typedef short bf16x8 __attribute__((ext_vector_type(8)));
typedef short s16x4 __attribute__((ext_vector_type(4)));
typedef float f32x2 __attribute__((ext_vector_type(2)));
typedef float f32x4 __attribute__((ext_vector_type(4)));
typedef float f32x16 __attribute__((ext_vector_type(16)));
typedef unsigned u32x2 __attribute__((ext_vector_type(2)));
typedef unsigned u32x4 __attribute__((ext_vector_type(4)));

constexpr int DM = 2048, NB = 4, SEQ = 4096, CTXL = 256;
constexpr int NLAT = NB * SEQ;
constexpr int NCTX = NB * CTXL;
constexpr int MROWS = NLAT + NCTX;
constexpr int DIN = 6176, DINP = 6400;
constexpr int C_GQ = 0, C_GK = 512, C_GV = 1024, C_GR = 2048, C_DQ = 3072, C_DK = 4096, C_DV = 5120, C_GLR = 6144;
constexpr int NE = 16, CAP = 512, MOE_ROWS = NE * NB * CAP;
constexpr float ALPHA = 1.189207115002721f;
constexpr float LAM_INIT = 0.2f;
constexpr int NCH = 68;

constexpr size_t MBy = 1u << 20;
constexpr size_t WS_CTL = 0;
constexpr size_t CTL_BYTES = 64 * 1024;
constexpr size_t WS_MOD = 64 * 1024;
constexpr size_t WS_ROPE = 320 * 1024;
constexpr size_t WS_LAM = 330 * 1024;
constexpr size_t WS_AFF = 1 * MBy;
constexpr size_t WS_INV = 2 * MBy;
constexpr size_t WS_SELIDX = 3 * MBy;
constexpr size_t WS_SELGATE = 3 * MBy + 128 * 1024;
constexpr size_t WS_W13T = 4 * MBy;
constexpr size_t WS_W2T = 260 * MBy;
constexpr size_t WS_WOT = 388 * MBy;
constexpr size_t WS_WINT = 396 * MBy;
constexpr size_t WS_S = 422 * MBy;
constexpr size_t WS_U = WS_S;
constexpr size_t WS_P = WS_S + 68 * MBy;
constexpr size_t WS_A2 = WS_S + 281 * MBy;
constexpr size_t WS_QF = WS_S + 345 * MBy;
constexpr size_t WS_KF = WS_S + 379 * MBy;
constexpr size_t WS_AF = WS_S + 413 * MBy;
constexpr size_t WS_DEC = WS_S + 430 * MBy;
constexpr size_t WS_VF = WS_S + 432 * MBy;
constexpr size_t WS_OF = WS_S + 466 * MBy;
constexpr size_t WS_OB = WS_S + 530 * MBy;
constexpr size_t WS_V1 = WS_S;
constexpr size_t WS_X1 = WS_S + 128 * MBy;
constexpr size_t WS_H = WS_S + 345 * MBy;
constexpr size_t WS_XS = WS_S;
constexpr size_t WS_HID = WS_S + 409 * MBy;
constexpr size_t WS_Y = WS_S;
constexpr size_t WS_END = WS_S + 594 * MBy;

constexpr int NTHR = 512;
constexpr int LDS_BYTES = 152 * 1024;
constexpr int LDS_MISC = 148 * 1024;

__device__ __forceinline__ unsigned cvt_pk_bf16(float lo, float hi) { unsigned r; asm volatile("v_cvt_pk_bf16_f32 %0, %1, %2" : "=v"(r) : "v"(lo), "v"(hi)); return r; }
__device__ __forceinline__ float bf2f(bf16_t b) { return __uint_as_float(((unsigned)b) << 16); }
__device__ __forceinline__ bf16_t f2bf(float f) { return (bf16_t)(cvt_pk_bf16(f, 0.f) & 0xffffu); }
__device__ __forceinline__ float wave_sum(float v) { for (int o = 32; o >= 1; o >>= 1) v += __shfl_xor(v, o); return v; }
__device__ __forceinline__ float wave_max(float v) { for (int o = 32; o >= 1; o >>= 1) v = fmaxf(v, __shfl_xor(v, o)); return v; }

#define XB_TMO      128
#define XB_XCNT(j)  (256  + 64 * (j))
#define XB_XSUB(j)  (1280 + 64 * (j))
#define XB_XGEN(j)  (2304 + 64 * (j))
#define XB_TOP      3328
#define XB_TOPGEN   3392
#define XCD_BAR_WORDS 3456
#define XB_SPIN_CAP (1u << 18)

__device__ __forceinline__ unsigned xb_ld(unsigned* p)              { return __hip_atomic_load(p, __ATOMIC_RELAXED, __HIP_MEMORY_SCOPE_AGENT); }
__device__ __forceinline__ unsigned xb_add(unsigned* p, unsigned v) { return __hip_atomic_fetch_add(p, v, __ATOMIC_RELAXED, __HIP_MEMORY_SCOPE_AGENT); }
__device__ __forceinline__ unsigned xb_xcc_id() { return (unsigned)__builtin_amdgcn_s_getreg((3 << 11) | 20) & 0xFu; }
#define XB_SPIN(cond, bar) do { unsigned _sp = 0; while (cond) { __builtin_amdgcn_s_sleep(1); \
    if ((++_sp & 255u) == 0u) { if (xb_ld(&(bar)[XB_TMO])) break; if (_sp > XB_SPIN_CAP) { atomicAdd(&(bar)[XB_TMO], 1u); break; } } } } while (0)

struct XcdBarrier { unsigned* bar; unsigned x; volatile LAS unsigned* st; };

__device__ __forceinline__ XcdBarrier xcd_barrier_post(unsigned* bar, volatile LAS unsigned* st) {
    XcdBarrier b; b.bar = bar; b.x = xb_xcc_id(); b.st = st;
    if (threadIdx.x == 0) (void)xb_add(&bar[XB_XCNT(b.x)], 1u);
    return b;
}
__device__ __forceinline__ void xcd_barrier_complete(unsigned* bar, unsigned x, unsigned& nloc, unsigned& nx) {
    const unsigned G = gridDim.x * gridDim.y * gridDim.z;
    unsigned sum, cnt, mine, sp = 0u;
    for (;;) {
        sum = 0u; cnt = 0u; mine = 0u;
#pragma unroll
        for (unsigned j = 0; j < 16; ++j) { const unsigned c = xb_ld(&bar[XB_XCNT(j)]); sum += c; cnt += (c > 0u) ? 1u : 0u; mine = (j == x) ? c : mine; }
        if (sum == G) break;
        __builtin_amdgcn_s_sleep(1);
        if ((++sp & 255u) == 0u) { if (xb_ld(&bar[XB_TMO])) break; if (sp > XB_SPIN_CAP) { atomicAdd(&bar[XB_TMO], 1u); break; } }
    }
    nloc = mine > 0u ? mine : 1u; nx = cnt > 0u ? cnt : 1u;
}
__device__ __forceinline__ void xcd_barrier(const XcdBarrier& b) {
    asm volatile("s_waitcnt vmcnt(0)" ::: "memory");
    __syncthreads();
    if (threadIdx.x == 0) {
        unsigned* bar = b.bar;
        __builtin_amdgcn_s_waitcnt(0);
        unsigned nloc = b.st[0], nx = b.st[1];
        if (nloc == 0u) { xcd_barrier_complete(bar, b.x, nloc, nx); b.st[0] = nloc; b.st[1] = nx; }
        const unsigned old = xb_add(&bar[XB_XSUB(b.x)], 1u);
        const unsigned gen = old / nloc;
        if (old + 1u == (gen + 1u) * nloc) {
            __builtin_amdgcn_fence(__ATOMIC_RELEASE, "agent");
            asm volatile("s_waitcnt vmcnt(0)" ::: "memory");
            const unsigned og = xb_add(&bar[XB_TOP], 1u);
            const unsigned tg = og / nx;
            if (og + 1u == (tg + 1u) * nx) xb_add(&bar[XB_TOPGEN], 1u);
            else XB_SPIN(xb_ld(&bar[XB_TOPGEN]) == tg, bar);
            __builtin_amdgcn_fence(__ATOMIC_ACQUIRE, "agent");
            xb_add(&bar[XB_XGEN(b.x)], 1u);
            asm volatile("s_waitcnt vmcnt(0)" ::: "memory");
        } else {
            XB_SPIN(xb_ld(&bar[XB_XGEN(b.x)]) == gen, bar);
            __builtin_amdgcn_fence(__ATOMIC_ACQUIRE, "agent");
            asm volatile("s_waitcnt vmcnt(0)" ::: "memory");
        }
    }
    __syncthreads();
}

namespace pg8 {
constexpr int BM = 256, BK = 64, HALF = 128, HTB = HALF * BK * 2, STAGE_BYTES = 8 * HTB, NXCD = 8, WGM = 8;
__host__ __device__ __forceinline__ int lds_byte(int r, int c) { const int st = (r >> 4) * 2 + (c >> 5), rr = r & 15, cc = c & 31, ob = rr * 64 + cc * 2; return st * 1024 + (ob ^ (((ob >> 9) & 1) << 5)); }
__host__ __device__ __forceinline__ void stage_rc(int b, int& R, int& C) { const int st = b / 1024, sb = b % 1024, swz = sb ^ (((sb >> 9) & 1) << 5); R = (st >> 1) * 16 + swz / 64; C = (st & 1) * 32 + (swz % 64) / 2; }
__host__ __device__ __forceinline__ int perm32(int rho) { const int n = rho >> 4, i = rho & 15; return 8 * (i >> 2) + 4 * n + (i & 3); }

struct Unit { int pm, pn; };
struct Gemm { const bf16_t* A; const bf16_t* Bt; int M, N, K; };

struct StaticOrder {
    int nM, nN, nwg, G, c;
    __host__ __device__ void init(int M, int N, int G_, int c_) { nM = M / BM; nN = N / BM; nwg = nM * nN; G = G_; c = c_; }
    __host__ __device__ bool next(int i, Unit& u) const {
        const long L = (long)i * G + c; if (L >= nwg) return false;
        int wgid = (int)L; { const int q = nwg / NXCD, r = nwg % NXCD, xcd = wgid % NXCD, off = wgid / NXCD; wgid = (xcd < r ? xcd * (q + 1) : r * (q + 1) + (xcd - r) * q) + off; }
        const int nig = WGM * nN, gid = wgid / nig, fm = gid * WGM, gsz = (nM - fm) < WGM ? (nM - fm) : WGM;
        u.pm = fm + ((wgid % nig) % gsz); u.pn = (wgid % nig) / gsz; return true;
    }
    __device__ __forceinline__ void a_ready(const Unit&) const {}
    __device__ __forceinline__ void done(const Unit&) const {}
};
struct MoeOrder : StaticOrder {
    __host__ __device__ bool next(int i, Unit& u) const { if (!StaticOrder::next(i, u)) return false; u.pn += (u.pm >> 3) * nN; return true; }
};

template <class Epi, class Sched>
__device__ __forceinline__ void gemm_phase(LAS unsigned char* lds, const Gemm g, const Sched& S, const Epi& E) {
    const int tid = threadIdx.x, wid = __builtin_amdgcn_readfirstlane(tid >> 6), lane = tid & 63, wr = wid >> 2, wc = wid & 3, fr = lane & 15, fq = lane >> 4;
    const int K = g.K, nt = K / BK;
    unsigned voffA[2], voffB[2];
#pragma unroll
    for (int i = 0; i < 2; ++i) { int R, C; stage_rc(tid * 16 + i * 8192, R, C); const int Rb = Epi::PERM ? ((R & ~31) + perm32(R & 31)) : R;
        voffA[i] = (unsigned)(R * K + C) * 2u; voffB[i] = (unsigned)(Rb * K + C) * 2u; }
    const size_t kstep = (size_t)(BK * 2);
    const size_t hstep = (size_t)HALF * K * 2;
    const size_t tstep = 2 * hstep;
    const unsigned ldsw = (unsigned)wid * 1024u;
    const int aoff = lds_byte(wr * 64 + fr, fq * 8), boff = lds_byte(wc * 32 + fr, fq * 8);
#define PG8_SA(b, h) (((b) * 2 + (h)) * HTB)
#define PG8_SB(b, h) ((4 + (b) * 2 + (h)) * HTB)
#define PG8_STAGE(bufoff, gbase, voff) do { _Pragma("unroll") for (int _i = 0; _i < 2; ++_i) \
        __builtin_amdgcn_global_load_lds((const unsigned*)((const char*)(gbase) + (voff)[_i]), (LAS unsigned*)(lds + (bufoff) + ldsw + _i * 8192), 16, 0, 0); } while (0)
#define PG8_LDA(dst, b, h) do { _Pragma("unroll") for (int m = 0; m < 4; ++m) _Pragma("unroll") for (int k = 0; k < 2; ++k) dst[m][k] = *(const LAS bf16x8*)(lds + PG8_SA(b, h) + aoff + m * 2048 + k * 1024); } while (0)
#define PG8_LDB(dst, b, h) do { _Pragma("unroll") for (int n = 0; n < 2; ++n) _Pragma("unroll") for (int k = 0; k < 2; ++k) dst[n][k] = *(const LAS bf16x8*)(lds + PG8_SB(b, h) + boff + n * 2048 + k * 1024); } while (0)
#define PG8_MMA(ai, bj, At, Bt) do { __builtin_amdgcn_s_setprio(1); _Pragma("unroll") for (int m = 0; m < 4; ++m) _Pragma("unroll") for (int n = 0; n < 2; ++n) _Pragma("unroll") for (int k = 0; k < 2; ++k) \
        acc[ai][bj][m][n] = __builtin_amdgcn_mfma_f32_16x16x32_bf16(Bt[n][k], At[m][k], acc[ai][bj][m][n], 0, 0, 0); __builtin_amdgcn_s_setprio(0); } while (0)
#define PG8_WAIT_V(n) asm volatile("s_waitcnt vmcnt(" #n ")" ::: "memory")
#define PG8_WAIT_L(n) asm volatile("s_waitcnt lgkmcnt(" #n ")" ::: "memory")
#define PG8_BAR __builtin_amdgcn_s_barrier()
#define PG8_SCHED __builtin_amdgcn_sched_barrier(0)
    Unit cur, nxt; int ui = 0;
    if (!S.next(0, cur)) return;
    f32x4 acc[2][2][4][2];
#pragma unroll
    for (int a = 0; a < 2; ++a)
#pragma unroll
        for (int b = 0; b < 2; ++b)
#pragma unroll
            for (int m = 0; m < 4; ++m)
#pragma unroll
                for (int n = 0; n < 2; ++n) acc[a][b][m][n] = (f32x4){0.f, 0.f, 0.f, 0.f};
    bf16x8 At[4][2], B0[2][2], B1[2][2];
    const char* cA = (const char*)g.A + (size_t)cur.pm * tstep; const char* cB = (const char*)g.Bt + (size_t)cur.pn * tstep;
    S.a_ready(cur);
    PG8_STAGE(PG8_SB(0, 0), cB, voffB); PG8_STAGE(PG8_SA(0, 0), cA, voffA); PG8_STAGE(PG8_SB(0, 1), cB + hstep, voffB); PG8_STAGE(PG8_SA(0, 1), cA + hstep, voffA);
    if (wr == 1) PG8_BAR;
    PG8_WAIT_V(4); PG8_BAR;
    PG8_STAGE(PG8_SB(1, 0), cB + kstep, voffB); PG8_STAGE(PG8_SA(1, 0), cA + kstep, voffA); PG8_STAGE(PG8_SB(1, 1), cB + hstep + kstep, voffB);
    PG8_WAIT_V(6); PG8_BAR;
    for (;;) {
        const bool has_next = S.next(ui + 1, nxt);
        const char* nA = has_next ? (const char*)g.A + (size_t)nxt.pm * tstep : cA; const char* nB = has_next ? (const char*)g.Bt + (size_t)nxt.pn * tstep : cB;
        for (int t = 0; t < nt; t += 2) {
            const bool last = (t == nt - 2);
            const char* a1 = cA + (size_t)(t + 1) * kstep;
            const char* a2 = last ? nA : cA + (size_t)(t + 2) * kstep; const char* b2 = last ? nB : cB + (size_t)(t + 2) * kstep;
            const char* a3 = a2 + kstep; const char* b3 = b2 + kstep;
            if (last && has_next) S.a_ready(nxt);
            PG8_LDB(B0, 0, 0); PG8_SCHED; PG8_LDA(At, 0, 0); PG8_STAGE(PG8_SA(1, 1), a1 + hstep, voffA);
            PG8_WAIT_L(8); PG8_BAR; PG8_WAIT_L(0); PG8_MMA(0, 0, At, B0); PG8_BAR; PG8_SCHED;
            PG8_LDB(B1, 0, 1); PG8_STAGE(PG8_SB(0, 0), b2, voffB);
            PG8_BAR; PG8_WAIT_L(0); PG8_MMA(0, 1, At, B1); PG8_BAR;
            PG8_LDA(At, 0, 1); PG8_STAGE(PG8_SA(0, 0), a2, voffA);
            PG8_BAR; PG8_WAIT_L(0); PG8_MMA(1, 0, At, B0); PG8_BAR; PG8_SCHED;
            PG8_STAGE(PG8_SB(0, 1), b2 + hstep, voffB);
            PG8_WAIT_V(6); PG8_BAR; PG8_MMA(1, 1, At, B1); PG8_BAR;
            PG8_LDB(B0, 1, 0); PG8_SCHED; PG8_LDA(At, 1, 0); PG8_STAGE(PG8_SA(0, 1), a2 + hstep, voffA);
            PG8_WAIT_L(8); PG8_BAR; PG8_WAIT_L(0); PG8_MMA(0, 0, At, B0); PG8_BAR; PG8_SCHED;
            PG8_LDB(B1, 1, 1); PG8_STAGE(PG8_SB(1, 0), b3, voffB);
            PG8_BAR; PG8_WAIT_L(0); PG8_MMA(0, 1, At, B1); PG8_BAR;
            PG8_LDA(At, 1, 1); PG8_STAGE(PG8_SA(1, 0), a3, voffA);
            PG8_BAR; PG8_WAIT_L(0); PG8_MMA(1, 0, At, B0); PG8_BAR; PG8_SCHED;
            PG8_STAGE(PG8_SB(1, 1), b3 + hstep, voffB);
            PG8_WAIT_V(6); PG8_BAR; PG8_MMA(1, 1, At, B1); PG8_BAR;
        }
        E(acc, cur, wr, wc, fr, fq); S.done(cur);
        if (!has_next) break;
#pragma unroll
        for (int a = 0; a < 2; ++a)
#pragma unroll
            for (int b = 0; b < 2; ++b)
#pragma unroll
                for (int m = 0; m < 4; ++m)
#pragma unroll
                    for (int n = 0; n < 2; ++n) acc[a][b][m][n] = (f32x4){0.f, 0.f, 0.f, 0.f};
        cur = nxt; cA = nA; cB = nB; ++ui;
    }
    PG8_WAIT_V(0);
    if (wr == 0) PG8_BAR;
    PG8_BAR;
#undef PG8_SA
#undef PG8_SB
#undef PG8_STAGE
#undef PG8_LDA
#undef PG8_LDB
#undef PG8_MMA
#undef PG8_WAIT_V
#undef PG8_WAIT_L
#undef PG8_BAR
#undef PG8_SCHED
}


struct EpiInProj {
    static constexpr bool PERM = true;
    bf16_t* P; const float* rope;
    __device__ __forceinline__ void operator()(const f32x4 (&acc)[2][2][4][2], const Unit& u, int wr, int wc, int fr, int fq) const {
        const int row0 = u.pm * BM + wr * 64 + fr, col0 = u.pn * BM + wc * 32 + 8 * fq;
        const bool rope_tile = (u.pn >= 12 && u.pn < 20 && u.pm < 64);
#pragma unroll
        for (int ai = 0; ai < 2; ++ai)
#pragma unroll
            for (int m = 0; m < 4; ++m) {
                const int row = row0 + ai * HALF + m * 16; bf16_t* rowp = P + (size_t)row * DINP + col0;
                const int n = row & 4095, prow = n >> 6, pcol = n & 63;
#pragma unroll
                for (int bj = 0; bj < 2; ++bj) {
                    f32x4 v0 = acc[ai][bj][m][0], v1 = acc[ai][bj][m][1];
                    if (rope_tile) {
                        const int c = col0 + bj * HALF, j0 = (c & 63) >> 1, pos = j0 < 16 ? prow : pcol, f0 = j0 & 15;
                        const f32x4* t = (const f32x4*)(rope + (pos * 16 + f0) * 2);
                        const f32x4 t0 = t[0], t1 = t[1];
                        float a, b;
                        a = v0[0]; b = v0[1]; v0[0] = a * t0[0] - b * t0[1]; v0[1] = a * t0[1] + b * t0[0];
                        a = v0[2]; b = v0[3]; v0[2] = a * t0[2] - b * t0[3]; v0[3] = a * t0[3] + b * t0[2];
                        a = v1[0]; b = v1[1]; v1[0] = a * t1[0] - b * t1[1]; v1[1] = a * t1[1] + b * t1[0];
                        a = v1[2]; b = v1[3]; v1[2] = a * t1[2] - b * t1[3]; v1[3] = a * t1[3] + b * t1[2];
                    }
                    u32x4 w; w.x = cvt_pk_bf16(v0[0], v0[1]); w.y = cvt_pk_bf16(v0[2], v0[3]); w.z = cvt_pk_bf16(v1[0], v1[1]); w.w = cvt_pk_bf16(v1[2], v1[3]);
                    *(u32x4*)(rowp + bj * HALF) = w;
                }
            }
    }
};
struct EpiOutProj {
    static constexpr bool PERM = false;
    float* V1; const float* x; const float* mod;
    __device__ __forceinline__ void operator()(const f32x4 (&acc)[2][2][4][2], const Unit& u, int wr, int wc, int fr, int fq) const {
        const int row0 = u.pm * BM + wr * 64 + fr, col0 = u.pn * BM + wc * 32 + 4 * fq;
        const int b = (u.pm * BM) >> 12;
        f32x4 gv[2][2];
#pragma unroll
        for (int bj = 0; bj < 2; ++bj)
#pragma unroll
            for (int n = 0; n < 2; ++n) gv[bj][n] = *(const f32x4*)(mod + b * 12288 + 2 * DM + col0 + bj * HALF + n * 16);
#pragma unroll
        for (int ai = 0; ai < 2; ++ai)
#pragma unroll
            for (int m = 0; m < 4; ++m) {
                const size_t ro = (size_t)(row0 + ai * HALF + m * 16) * DM + col0;
#pragma unroll
                for (int bj = 0; bj < 2; ++bj)
#pragma unroll
                    for (int n = 0; n < 2; ++n) {
                        const f32x4 xv = *(const f32x4*)(x + ro + bj * HALF + n * 16);
                        *(f32x4*)(V1 + ro + bj * HALF + n * 16) = xv * ALPHA + gv[bj][n] * acc[ai][bj][m][n];
                    }
            }
    }
};
struct EpiMoeUp {
    static constexpr bool PERM = true;
    bf16_t* HID;
    __device__ __forceinline__ void operator()(const f32x4 (&acc)[2][2][4][2], const Unit& u, int wr, int wc, int fr, int fq) const {
        const int row0 = u.pm * BM + wr * 64 + fr, col0 = (u.pn & 15) * HALF + wc * 32 + 8 * fq;
#pragma unroll
        for (int ai = 0; ai < 2; ++ai)
#pragma unroll
            for (int m = 0; m < 4; ++m) {
                bf16_t* rowp = HID + (size_t)(row0 + ai * HALF + m * 16) * DM + col0;
                float h[8];
#pragma unroll
                for (int n = 0; n < 2; ++n)
#pragma unroll
                    for (int j = 0; j < 4; ++j) { const float a = acc[ai][0][m][n][j], b = acc[ai][1][m][n][j]; h[n * 4 + j] = a * b / (1.0f + __expf(-a)); }
                u32x4 w; w.x = cvt_pk_bf16(h[0], h[1]); w.y = cvt_pk_bf16(h[2], h[3]); w.z = cvt_pk_bf16(h[4], h[5]); w.w = cvt_pk_bf16(h[6], h[7]);
                *(u32x4*)rowp = w;
            }
    }
};
struct EpiMoeDown {
    static constexpr bool PERM = true;
    bf16_t* Y; const float* gate;
    __device__ __forceinline__ void operator()(const f32x4 (&acc)[2][2][4][2], const Unit& u, int wr, int wc, int fr, int fq) const {
        const int row0 = u.pm * BM + wr * 64 + fr, col0 = (u.pn & 7) * BM + wc * 32 + 8 * fq;
#pragma unroll
        for (int ai = 0; ai < 2; ++ai)
#pragma unroll
            for (int m = 0; m < 4; ++m) {
                const int row = row0 + ai * HALF + m * 16; const float gt = gate[row];
                bf16_t* rowp = Y + (size_t)row * DM + col0;
#pragma unroll
                for (int bj = 0; bj < 2; ++bj) {
                    const f32x4 v0 = acc[ai][bj][m][0] * gt, v1 = acc[ai][bj][m][1] * gt;
                    u32x4 w; w.x = cvt_pk_bf16(v0[0], v0[1]); w.y = cvt_pk_bf16(v0[2], v0[3]); w.z = cvt_pk_bf16(v1[0], v1[1]); w.w = cvt_pk_bf16(v1[2], v1[3]);
                    *(u32x4*)(rowp + bj * HALF) = w;
                }
            }
    }
};
}

struct Args {
    const float* in[21]; float* out; unsigned char* ws; int ph_lo, ph_hi;
};
struct Frame {
    char* lds; LAS unsigned char* ldsL; int tid, lane, wave, G, bid;
    unsigned char* ws;
};

__device__ __forceinline__ void phase_mod(const Frame& F, const float* c, const float* c_ctx, const float* w_ada, const float* b_ada, const float* diff_lambda) {
    float* sl = (float*)F.lds;
    float* red = sl + 5 * 2048;
    for (int i = F.tid; i < 5 * 2048; i += NTHR) { const int b = i >> 11, k = i & 2047; const float v = b < 4 ? c[b * 2048 + k] : c_ctx[k]; sl[i] = v / (1.0f + expf(-v)); }
    __syncthreads();
    float* mod = (float*)(F.ws + WS_MOD);
    for (int u = F.bid; u < 256; u += F.G) {
        const int kg = F.tid / 12, q = F.tid % 12;
        float acc[5][4];
#pragma unroll
        for (int b = 0; b < 5; ++b)
#pragma unroll
            for (int j = 0; j < 4; ++j) acc[b][j] = 0.f;
        if (kg < 42) {
            for (int k = kg; k < 2048; k += 42) {
                const f32x4 w = *(const f32x4*)(w_ada + (size_t)k * 12288 + u * 48 + q * 4);
#pragma unroll
                for (int b = 0; b < 5; ++b) { const float s = sl[b * 2048 + k];
#pragma unroll
                    for (int j = 0; j < 4; ++j) acc[b][j] += s * w[j]; }
            }
#pragma unroll
            for (int b = 0; b < 5; ++b)
#pragma unroll
                for (int j = 0; j < 4; ++j) red[(kg * 5 + b) * 48 + q * 4 + j] = acc[b][j];
        }
        __syncthreads();
        if (F.tid < 240) { const int b = F.tid / 48, col = F.tid % 48; float s = 0.f; for (int g = 0; g < 42; ++g) s += red[(g * 5 + b) * 48 + col]; mod[b * 12288 + u * 48 + col] = s + b_ada[u * 48 + col]; }
        __syncthreads();
    }
    if (F.bid == 0) {
        float* rope = (float*)(F.ws + WS_ROPE);
        for (int t = F.tid; t < 1024; t += NTHR) {
            const int pos = t >> 4, f = t & 15;
            double th = 1.0; for (int i = 0; i < f; ++i) th *= 0.56234132519034908;
            double s1 = 0.0, c1 = 0.0, term = 1.0;
            for (int n = 0; n < 24; ++n) { if ((n & 1) == 0) c1 += ((n & 2) ? -term : term); else s1 += ((n & 2) ? -term : term); term *= th / (double)(n + 1); }
            double cr = 1.0, sr = 0.0; for (int i = 0; i < pos; ++i) { const double nc = cr * c1 - sr * s1, ns = sr * c1 + cr * s1; cr = nc; sr = ns; }
            rope[t * 2] = (float)cr; rope[t * 2 + 1] = (float)sr;
        }
        if (F.tid == 0) {
            float s1 = 0.f, s2 = 0.f; for (int i = 0; i < 64; ++i) { s1 += diff_lambda[i] * diff_lambda[64 + i]; s2 += diff_lambda[128 + i] * diff_lambda[192 + i]; }
            *(float*)(F.ws + WS_LAM) = expf(s1) - expf(s2) + LAM_INIT;
        }
    }
}

__device__ __forceinline__ void conv_tile(const Frame& F, const float* src, int ldsrc, bf16_t* dst, int mode, int nvalid) {
    float* T = (float*)F.lds;
    const int tid = F.tid;
    if (nvalid > 0) {
        const int c4 = tid & 15, kr = tid >> 4;
#pragma unroll
        for (int i = 0; i < 4; ++i) { const int k = kr + 32 * i; const f32x4 w = *(const f32x4*)(src + (size_t)k * ldsrc + 4 * c4);
#pragma unroll
            for (int j = 0; j < 4; ++j) T[(4 * c4 + j) * 129 + k] = w[j]; }
    }
    __syncthreads();
    {
        const int rl = tid >> 3, seg = tid & 7;
        const int p = mode == 1 ? ((rl >> 1) + 32 * (rl & 1)) : rl;
        u32x4 w0 = {0u, 0u, 0u, 0u}, w1 = {0u, 0u, 0u, 0u};
        if (rl < nvalid) {
            const float* tp = T + p * 129 + seg * 16;
            w0.x = cvt_pk_bf16(tp[0], tp[1]); w0.y = cvt_pk_bf16(tp[2], tp[3]); w0.z = cvt_pk_bf16(tp[4], tp[5]); w0.w = cvt_pk_bf16(tp[6], tp[7]);
            w1.x = cvt_pk_bf16(tp[8], tp[9]); w1.y = cvt_pk_bf16(tp[10], tp[11]); w1.z = cvt_pk_bf16(tp[12], tp[13]); w1.w = cvt_pk_bf16(tp[14], tp[15]);
        }
        bf16_t* d = dst + (size_t)rl * 2048 + seg * 16;
        *(u32x4*)d = w0; *(u32x4*)(d + 8) = w1;
    }
    __syncthreads();
}
constexpr int NT_WIN = 100 * 16, NT_WO = 32 * 16, NT_EXP = 16 * 512;
__device__ __forceinline__ void phase_convert(const Frame& F, const float* w_in, const float* w_o, const float* w1, const float* w3, const float* w2) {
    for (int t = F.bid; t < NT_WIN; t += F.G) {
        const int ct = t >> 4, kt = t & 15; const int c0 = ct * 64;
        int s0, mode = 0, nvalid = 64;
        if (c0 < 3072) s0 = c0;
        else if (c0 < 5120) { const int cc = c0 - 3072; s0 = (cc < 1024 ? 3104 : 4128) + (cc & 1023); mode = 1; }
        else if (c0 < 6144) s0 = 5152 + (c0 - 5120);
        else if (c0 == 6144) { s0 = 3072; nvalid = 32; }
        else { s0 = 0; nvalid = 0; }
        conv_tile(F, w_in + (size_t)kt * 128 * DIN + s0, DIN, (bf16_t*)(F.ws + WS_WINT) + (size_t)c0 * 2048 + kt * 128, mode, nvalid);
    }
    for (int t = F.bid; t < NT_WO; t += F.G) {
        const int ct = t >> 4, kt = t & 15;
        conv_tile(F, w_o + (size_t)kt * 128 * DM + ct * 64, DM, (bf16_t*)(F.ws + WS_WOT) + (size_t)ct * 64 * 2048 + kt * 128, 0, 64);
    }
    for (int t = F.bid; t < NT_EXP; t += F.G) {
        const int e = t >> 9, r2 = t & 511, ct = r2 >> 4, kt = r2 & 15;
        conv_tile(F, w1 + (size_t)e * DM * DM + (size_t)kt * 128 * DM + ct * 64, DM, (bf16_t*)(F.ws + WS_W13T) + ((size_t)e * 4096 + (ct >> 1) * 256 + (ct & 1) * 64) * 2048 + kt * 128, 0, 64);
    }
    for (int t = F.bid; t < NT_EXP; t += F.G) {
        const int e = t >> 9, r2 = t & 511, ct = r2 >> 4, kt = r2 & 15;
        conv_tile(F, w3 + (size_t)e * DM * DM + (size_t)kt * 128 * DM + ct * 64, DM, (bf16_t*)(F.ws + WS_W13T) + ((size_t)e * 4096 + (ct >> 1) * 256 + 128 + (ct & 1) * 64) * 2048 + kt * 128, 0, 64);
    }
    for (int t = F.bid; t < NT_EXP; t += F.G) {
        const int e = t >> 9, r2 = t & 511, ct = r2 >> 4, kt = r2 & 15;
        conv_tile(F, w2 + (size_t)e * DM * DM + (size_t)kt * 128 * DM + ct * 64, DM, (bf16_t*)(F.ws + WS_W2T) + ((size_t)e * 2048 + ct * 64) * 2048 + kt * 128, 0, 64);
    }
}

__device__ __forceinline__ void phase_u(const Frame& F, const float* x, const float* ctx) {
    const float* mod = (const float*)(F.ws + WS_MOD);
    bf16_t* U = (bf16_t*)(F.ws + WS_U);
    const size_t total = (size_t)MROWS * (DM / 8);
    for (size_t i = (size_t)F.bid * NTHR + F.tid; i < total; i += (size_t)F.G * NTHR) {
        const int row = (int)(i >> 8), d = (int)(i & 255) * 8;
        const float* src; int mb;
        if (row < NLAT) { src = x + (size_t)row * DM + d; mb = row >> 12; } else { src = ctx + (size_t)(row - NLAT) * DM + d; mb = 4; }
        const f32x4 a0 = *(const f32x4*)src, a1 = *(const f32x4*)(src + 4);
        const float* mp = mod + mb * 12288 + d;
        const f32x4 sh0 = *(const f32x4*)mp, sh1 = *(const f32x4*)(mp + 4), sc0 = *(const f32x4*)(mp + DM), sc1 = *(const f32x4*)(mp + DM + 4);
        const f32x4 r0 = a0 * (sc0 + 1.0f) + sh0, r1 = a1 * (sc1 + 1.0f) + sh1;
        u32x4 w; w.x = cvt_pk_bf16(r0[0], r0[1]); w.y = cvt_pk_bf16(r0[2], r0[3]); w.z = cvt_pk_bf16(r1[0], r1[1]); w.w = cvt_pk_bf16(r1[2], r1[3]);
        *(u32x4*)(U + (size_t)row * DM + d) = w;
    }
}

__device__ __forceinline__ size_t gla_row0(int b, int cn) { return cn < 4 ? (size_t)(NLAT + b * CTXL + cn * 64) : (size_t)(b * SEQ + (cn - 4) * 64); }
__device__ __forceinline__ void gla_pre_unit(const Frame& F, int unit, const float* w_gate2, const float* b_gate) {
    const int cn = unit % NCH, t1 = unit / NCH, h = t1 & 3, b = (t1 >> 2) & 3, dir = t1 >> 4;
    const int tid = F.tid, lane = F.lane, wid = F.wave;
    const bf16_t* Pr = (const bf16_t*)(F.ws + WS_P) + gla_row0(b, cn) * DINP;
    bf16_t* qs = (bf16_t*)F.lds;
    bf16_t* ks = qs + 64 * 136;
    bf16_t* as = ks + 64 * 136;
    bf16_t* vs = as + 64 * 72;
    float* gl = (float*)(vs + 64 * 264);
    float* tot = gl + 64 * 16;
    bf16_t* QFu = (bf16_t*)(F.ws + WS_QF) + (size_t)unit * 8192;
    bf16_t* KFu = (bf16_t*)(F.ws + WS_KF) + (size_t)unit * 8192;
    bf16_t* AFu = (bf16_t*)(F.ws + WS_AF) + (size_t)unit * 4096;
    float* DECu = (float*)(F.ws + WS_DEC) + (size_t)unit * 128;
    bf16_t* VFu = (bf16_t*)(F.ws + WS_VF) + (size_t)((b * 4 + h) * NCH + cn) * 16384;
    if (tid < 128) { const int row = tid >> 1, half = tid & 1; const bf16x8 g8 = *(const bf16x8*)(Pr + (size_t)row * DINP + C_GLR + dir * 16 + half * 8);
#pragma unroll
        for (int i = 0; i < 8; ++i) gl[row * 16 + half * 8 + i] = bf2f((bf16_t)g8[i]); }
    if (dir == 0) {
#pragma unroll
        for (int i = 0; i < 4; ++i) { const int p = tid + NTHR * i, row = p >> 5, c16 = p & 31;
            *(bf16x8*)(vs + row * 264 + c16 * 8) = *(const bf16x8*)(Pr + (size_t)row * DINP + C_GV + h * 256 + c16 * 8); }
    }
    __syncthreads();
    {
        const int dcol = tid & 127, tq = tid >> 7;
        float w2[16];
#pragma unroll
        for (int r = 0; r < 16; ++r) w2[r] = w_gate2[(dir * 16 + r) * 512 + h * 128 + dcol];
        const float bias = b_gate[dir * 512 + h * 128 + dcol];
        float cs[16];
#pragma unroll
        for (int i = 0; i < 16; ++i) {
            const float* g = gl + (16 * tq + i) * 16; float z = bias;
#pragma unroll
            for (int r = 0; r < 16; ++r) z += g[r] * w2[r];
            cs[i] = (fminf(z, 0.f) - log1pf(expf(-fabsf(z)))) * (1.0f / 16.0f);
        }
        if (dir == 0) {
#pragma unroll
            for (int i = 1; i < 16; ++i) cs[i] += cs[i - 1];
            tot[tq * 128 + dcol] = cs[15];
        } else {
#pragma unroll
            for (int i = 14; i >= 0; --i) cs[i] += cs[i + 1];
            tot[tq * 128 + dcol] = cs[0];
        }
        __syncthreads();
        float off = 0.f, btot = 0.f;
#pragma unroll
        for (int q = 0; q < 4; ++q) { const float tv = tot[q * 128 + dcol]; btot += tv; if (dir == 0 ? (q < tq) : (q > tq)) off += tv; }
        float ko[16];
#pragma unroll
        for (int i = 0; i < 16; ++i) {
            const int tok = 16 * tq + i; const float bc = cs[i] + off;
            const float qv = bf2f(Pr[(size_t)tok * DINP + C_GQ + h * 128 + dcol]) * 0.08838834764831845f;
            const float kv = bf2f(Pr[(size_t)tok * DINP + C_GK + h * 128 + dcol]);
            qs[tok * 136 + dcol] = f2bf(qv * expf(bc));
            ks[tok * 136 + dcol] = f2bf(kv * expf(-bc));
            ko[i] = kv * expf(btot - bc);
        }
        const int kb = dcol >> 5, r = dcol & 31;
#pragma unroll
        for (int hh = 0; hh < 2; ++hh) {
            u32x4 w; w.x = cvt_pk_bf16(ko[8 * hh + 0], ko[8 * hh + 1]); w.y = cvt_pk_bf16(ko[8 * hh + 2], ko[8 * hh + 3]); w.z = cvt_pk_bf16(ko[8 * hh + 4], ko[8 * hh + 5]); w.w = cvt_pk_bf16(ko[8 * hh + 6], ko[8 * hh + 7]);
            *(u32x4*)(KFu + ((size_t)((kb * 4 + tq) * 64 + hh * 32 + r)) * 8) = w;
        }
        if (tq == 0) DECu[dcol] = expf(btot);
    }
    __syncthreads();
    if (wid < 4) {
        const int jb = wid & 1, ib = wid >> 1, r32 = lane & 31, hi = lane >> 5;
        f32x16 acc = {};
#pragma unroll
        for (int kk = 0; kk < 8; ++kk) {
            const bf16x8 a = *(const bf16x8*)(ks + (32 * jb + r32) * 136 + 16 * kk + 8 * hi);
            const bf16x8 bq = *(const bf16x8*)(qs + (32 * ib + r32) * 136 + 16 * kk + 8 * hi);
            acc = __builtin_amdgcn_mfma_f32_32x32x16_bf16(a, bq, acc, 0, 0, 0);
        }
        const int i = 32 * ib + r32;
#pragma unroll
        for (int q4 = 0; q4 < 4; ++q4) {
            const int j0 = 32 * jb + 8 * q4 + 4 * hi;
            float v[4];
#pragma unroll
            for (int e = 0; e < 4; ++e) { const int j = j0 + e; const bool keep = dir == 0 ? (j <= i) : (j >= i); v[e] = keep ? acc[4 * q4 + e] : 0.f; }
            u32x2 w; w.x = cvt_pk_bf16(v[0], v[1]); w.y = cvt_pk_bf16(v[2], v[3]);
            *(u32x2*)(as + i * 72 + j0) = w;
        }
    }
    __syncthreads();
#pragma unroll
    for (int i2 = 0; i2 < 2; ++i2) {
        const int e = tid + NTHR * i2, frag = e >> 6, ln = e & 63, rr = ln & 31, hh = ln >> 5, tb = frag >> 3, kb = (frag >> 1) & 3, s = frag & 1;
        const bf16_t* qp = qs + (32 * tb + rr) * 136 + 32 * kb + 16 * s + 4 * hh;
        const u32x2 lo = *(const u32x2*)qp, hi2 = *(const u32x2*)(qp + 8);
        u32x4 w; w.x = lo.x; w.y = lo.y; w.z = hi2.x; w.w = hi2.y;
        *(u32x4*)(QFu + (size_t)e * 8) = w;
    }
    {
        const int e = tid, frag = e >> 6, ln = e & 63, rr = ln & 31, hh = ln >> 5, tb = frag >> 2, ksx = frag & 3;
        *(u32x4*)(AFu + (size_t)e * 8) = *(const u32x4*)(as + (32 * tb + rr) * 72 + 16 * ksx + 8 * hh);
    }
    if (dir == 0) {
#pragma unroll
        for (int i4 = 0; i4 < 4; ++i4) {
            const int e = tid + NTHR * i4, frag = e >> 6, ln = e & 63, rr = ln & 31, hh = ln >> 5, sg = frag >> 2, ksx = frag & 3;
            const bf16_t* vp = vs + (16 * ksx + 8 * hh) * 264 + 32 * sg + rr;
            unsigned short t8[8];
#pragma unroll
            for (int j = 0; j < 8; ++j) t8[j] = vp[j * 264];
            u32x4 w; w.x = t8[0] | ((unsigned)t8[1] << 16); w.y = t8[2] | ((unsigned)t8[3] << 16); w.z = t8[4] | ((unsigned)t8[5] << 16); w.w = t8[6] | ((unsigned)t8[7] << 16);
            *(u32x4*)(VFu + (size_t)e * 8) = w;
        }
    }
    __syncthreads();
}

constexpr int SC_STAGE = 46080;
__device__ __forceinline__ void gla_scan_unit(const Frame& F, int unit) {
    const int sg = unit & 7, scan = unit >> 3, dir = scan >> 4, b = (scan >> 2) & 3, h = scan & 3;
    const int lane = F.lane, wid = F.wave, r32 = lane & 31, hi = lane >> 5;
    LAS unsigned char* L = (LAS unsigned char*)F.lds;
    const unsigned char* QF = F.ws + WS_QF; const unsigned char* KF = F.ws + WS_KF; const unsigned char* AF = F.ws + WS_AF; const unsigned char* DEC = F.ws + WS_DEC; const unsigned char* VF = F.ws + WS_VF;
    float* Odir = (float*)(F.ws + (dir == 0 ? WS_OF : WS_OB));
#define SC_LOAD(s_, st_) do { const int cn_ = dir == 0 ? (s_) : ((s_) < 4 ? 3 - (s_) : 71 - (s_)); const size_t u_ = (size_t)scan * NCH + cn_; \
        const size_t uv_ = (size_t)((b * 4 + h) * NCH + cn_); \
        _Pragma("unroll") for (int i_ = 0; i_ < 6; ++i_) { int p_ = wid + 8 * i_; if (p_ > 44) p_ = 44; \
            const unsigned char* g_; int lo_; \
            if (p_ < 16) { g_ = QF + u_ * 16384 + p_ * 1024; lo_ = p_ * 1024; } \
            else if (p_ < 32) { g_ = KF + u_ * 16384 + (p_ - 16) * 1024; lo_ = p_ * 1024; } \
            else if (p_ < 40) { g_ = AF + u_ * 8192 + (p_ - 32) * 1024; lo_ = p_ * 1024; } \
            else if (p_ < 44) { g_ = VF + uv_ * 32768 + sg * 4096 + (p_ - 40) * 1024; lo_ = p_ * 1024; } \
            else { g_ = DEC + u_ * 512 - ((lane >> 5) * 512); lo_ = 44 * 1024; } \
            if (p_ < 44 || lane < 32) __builtin_amdgcn_global_load_lds((const unsigned*)(g_ + lane * 16), (LAS unsigned*)(L + (st_) * SC_STAGE + lo_), 16, 0, 0); } } while (0)
    f32x16 S[4] = {};
    SC_LOAD(0, 0); SC_LOAD(1, 1);
    for (int s = 0; s < NCH; ++s) {
        const int st = s % 3;
        if (s + 1 < NCH) asm volatile("s_waitcnt vmcnt(6)" ::: "memory"); else asm volatile("s_waitcnt vmcnt(0)" ::: "memory");
        __syncthreads();
        if (s + 2 < NCH) SC_LOAD(s + 2, (s + 2) % 3);
        if (wid == 0) {
            const LAS unsigned char* B = L + st * SC_STAGE;
            const int cn = dir == 0 ? s : (s < 4 ? 3 - s : 71 - s);
            bf16x8 vfr[4];
#pragma unroll
            for (int ks = 0; ks < 4; ++ks) vfr[ks] = *(const LAS bf16x8*)(B + 40960 + ks * 1024 + lane * 16);
            if (cn >= 4) {
                f32x16 oT[2] = {};
#pragma unroll
                for (int kb = 0; kb < 4; ++kb)
#pragma unroll
                    for (int sx = 0; sx < 2; ++sx) {
                        u32x4 w; w.x = cvt_pk_bf16(S[kb][8 * sx + 0], S[kb][8 * sx + 1]); w.y = cvt_pk_bf16(S[kb][8 * sx + 2], S[kb][8 * sx + 3]);
                        w.z = cvt_pk_bf16(S[kb][8 * sx + 4], S[kb][8 * sx + 5]); w.w = cvt_pk_bf16(S[kb][8 * sx + 6], S[kb][8 * sx + 7]);
                        bf16x8 sf; __builtin_memcpy(&sf, &w, 16);
#pragma unroll
                        for (int tb = 0; tb < 2; ++tb) {
                            const bf16x8 qf = *(const LAS bf16x8*)(B + ((tb * 8 + kb * 2 + sx) * 64 + lane) * 16);
                            oT[tb] = __builtin_amdgcn_mfma_f32_32x32x16_bf16(sf, qf, oT[tb], 0, 0, 0);
                        }
                    }
#pragma unroll
                for (int tb = 0; tb < 2; ++tb)
#pragma unroll
                    for (int ks = 0; ks < 4; ++ks) {
                        const bf16x8 af = *(const LAS bf16x8*)(B + 32768 + ((tb * 4 + ks) * 64 + lane) * 16);
                        oT[tb] = __builtin_amdgcn_mfma_f32_32x32x16_bf16(vfr[ks], af, oT[tb], 0, 0, 0);
                    }
#pragma unroll
                for (int tb = 0; tb < 2; ++tb) {
                    float* op = Odir + ((size_t)(b * SEQ + (cn - 4) * 64 + 32 * tb + r32)) * 1024 + h * 256 + 32 * sg + 4 * hi;
#pragma unroll
                    for (int q4 = 0; q4 < 4; ++q4) { f32x4 v = {oT[tb][4 * q4], oT[tb][4 * q4 + 1], oT[tb][4 * q4 + 2], oT[tb][4 * q4 + 3]}; *(f32x4*)(op + 8 * q4) = v; }
                }
            }
#pragma unroll
            for (int kb = 0; kb < 4; ++kb) {
#pragma unroll
                for (int q4 = 0; q4 < 4; ++q4) {
                    const f32x4 d4 = *(const LAS f32x4*)(B + 45056 + (32 * kb + 8 * q4 + 4 * hi) * 4);
#pragma unroll
                    for (int e = 0; e < 4; ++e) S[kb][4 * q4 + e] *= d4[e];
                }
#pragma unroll
                for (int ks = 0; ks < 4; ++ks) {
                    const bf16x8 kf = *(const LAS bf16x8*)(B + 16384 + ((kb * 4 + ks) * 64 + lane) * 16);
                    S[kb] = __builtin_amdgcn_mfma_f32_32x32x16_bf16(kf, vfr[ks], S[kb], 0, 0, 0);
                }
            }
        }
    }
    __syncthreads();
#undef SC_LOAD
}

__device__ __forceinline__ void phase_gla_combine(const Frame& F, const float* gla_norm_g) {
    const float* OFp = (const float*)(F.ws + WS_OF); const float* OBp = (const float*)(F.ws + WS_OB);
    const bf16_t* P = (const bf16_t*)(F.ws + WS_P); bf16_t* A2 = (bf16_t*)(F.ws + WS_A2);
    const f32x4 g4 = *(const f32x4*)(gla_norm_g + F.lane * 4);
    for (int t = F.bid * 8 + F.wave; t < NLAT * 4; t += F.G * 8) {
        const int row = t >> 2, h = t & 3;
        const size_t o = (size_t)row * 1024 + h * 256 + F.lane * 4;
        const f32x4 v = *(const f32x4*)(OFp + o) + *(const f32x4*)(OBp + o);
        float ss = v[0] * v[0] + v[1] * v[1] + v[2] * v[2] + v[3] * v[3];
        ss = wave_sum(ss);
        const float rs = rsqrtf(ss * (1.0f / 256.0f) + 1e-6f);
        const u32x2 rr = *(const u32x2*)(P + (size_t)row * DINP + C_GR + h * 256 + F.lane * 4);
        float r[4] = {__uint_as_float(rr.x << 16), __uint_as_float(rr.x & 0xffff0000u), __uint_as_float(rr.y << 16), __uint_as_float(rr.y & 0xffff0000u)};
        float y[4];
#pragma unroll
        for (int j = 0; j < 4; ++j) y[j] = v[j] * rs * g4[j] * (r[j] / (1.0f + expf(-r[j])));
        u32x2 w; w.x = cvt_pk_bf16(y[0], y[1]); w.y = cvt_pk_bf16(y[2], y[3]);
        *(u32x2*)(A2 + (size_t)row * DM + h * 256 + F.lane * 4) = w;
    }
}

namespace att {
constexpr float SCALE = 0.125f, THR = 8.f;
constexpr int SHM_V = 64 * 128 * 2, SHM_K = 64 * 128 * 2;
#define KSWZ(row, colB) ((row) * 256 + ((colB) ^ (((row) & 7) << 4)))
#define SBAR() __builtin_amdgcn_sched_barrier(0)
__device__ __forceinline__ int crow(int r, int hi) { return (r & 3) + 8 * (r >> 2) + 4 * hi; }
__device__ __forceinline__ void partialSM(f32x16& p0, f32x16& p1, float& m_reg, float& mn, float& alpha) {
    constexpr float C = SCALE * 1.4426950408889634f;
    float pmax = p0[0];
#pragma unroll
    for (int r = 1; r < 16; ++r) pmax = fmaxf(pmax, p0[r]);
#pragma unroll
    for (int r = 0; r < 16; ++r) pmax = fmaxf(pmax, p1[r]);
    { auto rr = __builtin_amdgcn_permlane32_swap(__float_as_uint(pmax), __float_as_uint(pmax), false, false);
      pmax = fmaxf(__uint_as_float(rr[0]), __uint_as_float(rr[1])); }
    if (__builtin_expect(__all(pmax - m_reg <= THR / SCALE), 1)) { mn = m_reg; alpha = 1.f; }
    else { mn = fmaxf(m_reg, pmax); alpha = __builtin_amdgcn_exp2f((m_reg - mn) * C); m_reg = mn; }
    const float mnC = -mn * C;
#pragma unroll
    for (int r = 0; r < 16; ++r) p0[r] = fmaf(p0[r], C, mnC);
#pragma unroll
    for (int r = 0; r < 16; ++r) p1[r] = fmaf(p1[r], C, mnC);
#pragma unroll
    for (int r = 0; r < 16; ++r) p0[r] = __builtin_amdgcn_exp2f(p0[r]);
}
__device__ __forceinline__ void finishSM(f32x16& p0, f32x16& p1, float alpha, float& l_reg, bf16x8& pa0, bf16x8& pa1, bf16x8& pa2, bf16x8& pa3) {
#pragma unroll
    for (int r = 0; r < 16; ++r) p1[r] = __builtin_amdgcn_exp2f(p1[r]);
    float ps = 0;
#pragma unroll
    for (int r = 0; r < 16; ++r) ps += p0[r];
#pragma unroll
    for (int r = 0; r < 16; ++r) ps += p1[r];
    { auto rr = __builtin_amdgcn_permlane32_swap(__float_as_uint(ps), __float_as_uint(ps), false, false);
      ps = __uint_as_float(rr[0]) + __uint_as_float(rr[1]); }
    l_reg = l_reg * alpha + ps;
#define PK4(P, BASE, OUT) do { unsigned a0 = cvt_pk_bf16(P[BASE + 0], P[BASE + 1]), a1 = cvt_pk_bf16(P[BASE + 2], P[BASE + 3]);   \
    unsigned b0 = cvt_pk_bf16(P[BASE + 4], P[BASE + 5]), b1 = cvt_pk_bf16(P[BASE + 6], P[BASE + 7]);                              \
    auto r0 = __builtin_amdgcn_permlane32_swap(a0, b0, false, false); auto r1 = __builtin_amdgcn_permlane32_swap(a1, b1, false, false); \
    u32x4 w = {r0[0], r1[0], r0[1], r1[1]}; __builtin_memcpy(&OUT, &w, 16); } while (0)
    PK4(p0, 0, pa0); PK4(p0, 8, pa1); PK4(p1, 0, pa2); PK4(p1, 8, pa3);
#undef PK4
}
template <int MAP> __device__ __forceinline__ void qkt_half(f32x16& p0, f32x16& p1, const char* Ks, const char* Qs, int r32, int hi) {
    p0 = f32x16{}; p1 = f32x16{};
#pragma unroll
    for (int d0 = 0; d0 < 4; ++d0) { const int cb = ((MAP * 4 + d0) * 16 + hi * 8) * 2;
        const bf16x8 b0 = *reinterpret_cast<const bf16x8*>(Ks + KSWZ(r32, cb));
        const bf16x8 b1 = *reinterpret_cast<const bf16x8*>(Ks + KSWZ(32 + r32, cb));
        const bf16x8 q = *reinterpret_cast<const bf16x8*>(Qs + KSWZ(r32, cb));
        p0 = __builtin_amdgcn_mfma_f32_32x32x16_bf16(b0, q, p0, 0, 0, 0);
        p1 = __builtin_amdgcn_mfma_f32_32x32x16_bf16(b1, q, p1, 0, 0, 0); }
}
__device__ __forceinline__ int v_st(int k, int c) { const int kk = (k & ~0xC) | ((k & 4) << 1) | ((k & 8) >> 1); return ((kk >> 3) * 4 + (c >> 5)) * 512 + ((kk & 7) * 32 + (c & 31)) * 2; }
__device__ __forceinline__ int v_rd_base(int lane) { return ((lane & 3) << 3) | (((lane >> 2) & 3) << 6) | (((lane >> 4) & 1) << 5) | (((lane >> 5) & 1) << 8); }
constexpr int v_rd_off(int d0, int ks, int half) { return d0 * 512 + ks * 4096 + half * 2048; }
template <int OFF> __device__ __forceinline__ s16x4 tr_read(int vb) {
    s16x4 r; asm volatile("ds_read_b64_tr_b16 %0, %1 offset:%2" : "=&v"(r) : "v"(vb), "i"(OFF) : "memory"); return r;
}
template <int D0> __device__ __forceinline__ void pv_one(f32x16& od, int vb, bf16x8 pa0, bf16x8 pa1, bf16x8 pa2, bf16x8 pa3) {
    const s16x4 l0 = tr_read<v_rd_off(D0, 0, 0)>(vb), h0 = tr_read<v_rd_off(D0, 0, 1)>(vb), l1 = tr_read<v_rd_off(D0, 1, 0)>(vb), h1 = tr_read<v_rd_off(D0, 1, 1)>(vb);
    const s16x4 l2 = tr_read<v_rd_off(D0, 2, 0)>(vb), h2 = tr_read<v_rd_off(D0, 2, 1)>(vb), l3 = tr_read<v_rd_off(D0, 3, 0)>(vb), h3 = tr_read<v_rd_off(D0, 3, 1)>(vb);
    asm volatile("s_waitcnt lgkmcnt(0)" ::: "memory"); SBAR();
#define PKV(L, H) (bf16x8){L[0], L[1], L[2], L[3], H[0], H[1], H[2], H[3]}
    od = __builtin_amdgcn_mfma_f32_32x32x16_bf16(pa0, PKV(l0, h0), od, 0, 0, 0);
    od = __builtin_amdgcn_mfma_f32_32x32x16_bf16(pa1, PKV(l1, h1), od, 0, 0, 0);
    od = __builtin_amdgcn_mfma_f32_32x32x16_bf16(pa2, PKV(l2, h2), od, 0, 0, 0);
    od = __builtin_amdgcn_mfma_f32_32x32x16_bf16(pa3, PKV(l3, h3), od, 0, 0, 0);
#undef PKV
}
__device__ __forceinline__ void pv_d0(f32x16* o, int vb, bf16x8 pa0, bf16x8 pa1, bf16x8 pa2, bf16x8 pa3) {
    pv_one<0>(o[0], vb, pa0, pa1, pa2, pa3); pv_one<1>(o[1], vb, pa0, pa1, pa2, pa3); pv_one<2>(o[2], vb, pa0, pa1, pa2, pa3); pv_one<3>(o[3], vb, pa0, pa1, pa2, pa3);
}
__device__ __forceinline__ size_t key_row0(int b, int kt) { return kt < 4 ? (size_t)(NLAT + b * CTXL + kt * 64) : (size_t)(b * SEQ + (kt - 4) * 64); }

constexpr int Q_OFF = 2 * SHM_V + 2 * SHM_K, WS_OFF = Q_OFF + 256 * 256;
__device__ __forceinline__ void attn_unit(const Frame& F, int b, int h, int qb, float lam, const float* diff_norm_g) {
    const char* P = (const char*)(F.ws + WS_P);
    char* lds = F.lds; LAS unsigned char* L = F.ldsL;
    const int wid = F.wave, lane = F.lane, r32 = lane & 31, hi = lane >> 5;
    char* V_lds = lds; char* K_lds = lds + 2 * SHM_V; const char* Qs = lds + Q_OFF + wid * 32 * 256;
    float* wsl = (float*)(lds + WS_OFF) + wid * 64; float* li_l = wsl; float* al_l = wsl + 32;
    float m1 = -1e30f, l1 = 0.f, m2 = -1e30f, l2 = 0.f; f32x16 o1[4] = {}, o2[4] = {};
    unsigned koff[2], voff[2];
#pragma unroll
    for (int i = 0; i < 2; ++i) {
        const int p = 2 * wid + i;
        { const int row = 4 * p + (lane >> 4), g = lane & 15; koff[i] = (unsigned)((row * DINP + C_DK + h * 128) * 2 + ((g ^ (row & 7)) * 16)); }
        { const int sub = 2 * p + (lane >> 5), kk = (sub >> 2) * 8 + ((lane & 31) >> 2), k = (kk & ~0xC) | ((kk & 4) << 1) | ((kk & 8) >> 1), c = (sub & 3) * 32 + (lane & 3) * 8;
          voff[i] = (unsigned)((k * DINP + C_DV + h * 128 + c) * 2); }
    }
    const int vb0 = (int)(uintptr_t)V_lds + v_rd_base(lane);
#define TLOAD(kt_, bf_) do { const char* tb_ = P + key_row0(b, (kt_)) * (size_t)(DINP * 2); \
        _Pragma("unroll") for (int i_ = 0; i_ < 2; ++i_) { \
            __builtin_amdgcn_global_load_lds((const unsigned*)(tb_ + koff[i_]), (LAS unsigned*)(L + 2 * SHM_V + (bf_) * SHM_K + (2 * wid + i_) * 1024), 16, 0, 0); \
            __builtin_amdgcn_global_load_lds((const unsigned*)(tb_ + voff[i_]), (LAS unsigned*)(L + (bf_) * SHM_V + (2 * wid + i_) * 1024), 16, 0, 0); } } while (0)
#define RESC(o_, a_) do { if (__any((a_) < 1.f)) { if (hi == 0) al_l[r32] = (a_); asm volatile("s_waitcnt lgkmcnt(0)" ::: "memory"); \
        _Pragma("unroll") for (int d_ = 0; d_ < 4; ++d_) _Pragma("unroll") for (int r_ = 0; r_ < 16; ++r_) o_[d_][r_] *= al_l[crow(r_, hi)]; } } while (0)
    {
        const char* qbase = P + (size_t)(b * SEQ + qb * 256 + wid * 32) * (DINP * 2) + (C_DQ + h * 128) * 2;
#pragma unroll
        for (int i = 0; i < 8; ++i) { const int row = 4 * i + (lane >> 4), g = lane & 15;
            __builtin_amdgcn_global_load_lds((const unsigned*)(qbase + (size_t)row * (DINP * 2) + ((g ^ (row & 7)) * 16)), (LAS unsigned*)(L + Q_OFF + (wid * 8 + i) * 1024), 16, 0, 0); }
    }
    TLOAD(0, 0);
    asm volatile("s_waitcnt vmcnt(0)" ::: "memory"); __syncthreads();
    constexpr int NT = NCH;
    for (int kt = 0; kt < NT; ++kt) {
        const int cur = kt & 1;
        if (kt + 1 < NT) TLOAD(kt + 1, cur ^ 1);
        f32x16 p0, p1; float mn, al; bf16x8 pa0, pa1, pa2, pa3;
        SBAR();
        qkt_half<0>(p0, p1, K_lds + cur * SHM_K, Qs, r32, hi);
        partialSM(p0, p1, m1, mn, al); RESC(o1, al);
        finishSM(p0, p1, al, l1, pa0, pa1, pa2, pa3); SBAR();
        pv_d0(o1, vb0 + cur * SHM_V, pa0, pa1, pa2, pa3);
        SBAR();
        qkt_half<1>(p0, p1, K_lds + cur * SHM_K, Qs, r32, hi);
        partialSM(p0, p1, m2, mn, al); RESC(o2, al);
        finishSM(p0, p1, al, l2, pa0, pa1, pa2, pa3); SBAR();
        pv_d0(o2, vb0 + cur * SHM_V, pa0, pa1, pa2, pa3);
        asm volatile("s_waitcnt vmcnt(0)" ::: "memory");
        __syncthreads();
    }
    if (hi == 0) { li_l[r32] = 1.0f / l1; al_l[r32] = lam / l2; }
    asm volatile("s_waitcnt lgkmcnt(0)" ::: "memory");
    int r32e = r32, hie = hi; asm volatile("" : "+v"(r32e), "+v"(hie));
    float gn[4];
#pragma unroll
    for (int d0 = 0; d0 < 4; ++d0) gn[d0] = diff_norm_g[d0 * 32 + r32e] * (1.0f - LAM_INIT);
    bf16_t* Ow = (bf16_t*)(F.ws + WS_A2) + (size_t)(b * SEQ + qb * 256 + wid * 32) * DM + 1024 + h * 128 + r32e;
#pragma unroll
    for (int r = 0; r < 16; ++r) {
        const int orow = crow(r, hie); const float i1 = li_l[orow], i2 = al_l[orow];
        float v[4], ss = 0.f;
#pragma unroll
        for (int d0 = 0; d0 < 4; ++d0) { v[d0] = o1[d0][r] * i1 - o2[d0][r] * i2; ss += v[d0] * v[d0]; }
        ss += __shfl_xor(ss, 1); ss += __shfl_xor(ss, 2); ss += __shfl_xor(ss, 4); ss += __shfl_xor(ss, 8); ss += __shfl_xor(ss, 16);
        const float rs = rsqrtf(ss * (1.0f / 128.0f) + 1e-6f);
#pragma unroll
        for (int d0 = 0; d0 < 4; ++d0) Ow[(size_t)orow * DM + d0 * 32] = f2bf(v[d0] * rs * gn[d0]);
    }
    __syncthreads();
#undef TLOAD
#undef RESC
}
}

__device__ __forceinline__ void phase_ln1(const Frame& F, const float* w_router, const float* ln1_g, const float* ln1_b) {
    float* wrT = (float*)F.lds;
    for (int i = F.tid; i < 32768; i += NTHR) { const int d = i >> 4, e = i & 15; wrT[e * 2048 + d] = w_router[i]; }
    __syncthreads();
    const float* V1 = (const float*)(F.ws + WS_V1); float* X1 = (float*)(F.ws + WS_X1); bf16_t* H = (bf16_t*)(F.ws + WS_H);
    const float* mod = (const float*)(F.ws + WS_MOD); float* aff = (float*)(F.ws + WS_AFF); int* inv = (int*)(F.ws + WS_INV);
    const int lane = F.lane;
    for (int row = F.bid * 8 + F.wave; row < NLAT; row += F.G * 8) {
        const int b = row >> 12;
        f32x4 v[8]; float s = 0.f;
#pragma unroll
        for (int i = 0; i < 8; ++i) { v[i] = *(const f32x4*)(V1 + (size_t)row * DM + 4 * (lane + 64 * i)); s += (v[i][0] + v[i][1]) + (v[i][2] + v[i][3]); }
        const float mu = wave_sum(s) * (1.0f / 2048.0f);
        float q = 0.f;
#pragma unroll
        for (int i = 0; i < 8; ++i) { const f32x4 d = v[i] - mu; q += (d[0] * d[0] + d[1] * d[1]) + (d[2] * d[2] + d[3] * d[3]); }
        const float rstd = rsqrtf(wave_sum(q) * (1.0f / 2048.0f) + 1e-5f);
        float part[16];
#pragma unroll
        for (int e = 0; e < 16; ++e) part[e] = 0.f;
#pragma unroll
        for (int i = 0; i < 8; ++i) {
            const int d = 4 * (lane + 64 * i);
            const f32x4 g = *(const f32x4*)(ln1_g + d), bb = *(const f32x4*)(ln1_b + d);
            const f32x4 x1 = (v[i] - mu) * rstd * g + bb;
            *(f32x4*)(X1 + (size_t)row * DM + d) = x1;
            const f32x4 sh = *(const f32x4*)(mod + b * 12288 + 3 * DM + d), sc = *(const f32x4*)(mod + b * 12288 + 4 * DM + d);
            const f32x4 hv = x1 * (sc + 1.0f) + sh;
            u32x2 w; w.x = cvt_pk_bf16(hv[0], hv[1]); w.y = cvt_pk_bf16(hv[2], hv[3]);
            *(u32x2*)(H + (size_t)row * DM + d) = w;
#pragma unroll
            for (int e = 0; e < 16; ++e) { const f32x4 wr = *(const f32x4*)(wrT + e * 2048 + d); part[e] += (hv[0] * wr[0] + hv[1] * wr[1]) + (hv[2] * wr[2] + hv[3] * wr[3]); }
        }
        float mine = 0.f, mx = -1e30f;
#pragma unroll
        for (int e = 0; e < 16; ++e) { const float t = wave_sum(part[e]); mx = fmaxf(mx, t); if (lane == e) mine = t; }
        float ex = lane < 16 ? expf(mine - mx) : 0.f;
        const float den = wave_sum(ex);
        if (lane < 16) { aff[(size_t)row * 16 + lane] = ex / den; inv[(size_t)row * 16 + lane] = -1; }
    }
    __syncthreads();
}

__device__ __forceinline__ void topk_unit(const Frame& F, int unit) {
    const int b = unit >> 4, e = unit & 15, tid = F.tid, lane = F.lane, wid = F.wave;
    const float* aff = (const float*)(F.ws + WS_AFF);
    unsigned* key = (unsigned*)F.lds;
    unsigned* hist = key + 4096;
    unsigned* sh = hist + 256;
    unsigned kv[8];
#pragma unroll
    for (int i = 0; i < 8; ++i) { const int n = tid * 8 + i; kv[i] = __float_as_uint(aff[(size_t)(b * SEQ + n) * 16 + e]); key[n] = kv[i]; }
    if (tid == 0) { sh[0] = 0u; sh[1] = CAP; }
    __syncthreads();
    for (int pass = 0; pass < 4; ++pass) {
        const int shift = 24 - 8 * pass;
        if (tid < 256) hist[tid] = 0u;
        __syncthreads();
        const unsigned prefix = sh[0]; const unsigned himask = pass == 0 ? 0u : (0xffffffffu << (shift + 8));
#pragma unroll
        for (int i = 0; i < 8; ++i) if ((kv[i] & himask) == prefix) atomicAdd(&hist[(kv[i] >> shift) & 255u], 1u);
        __syncthreads();
        if (wid == 0) {
            const unsigned kk = sh[1];
            unsigned c[4]; unsigned s = 0;
#pragma unroll
            for (int j = 0; j < 4; ++j) { c[j] = hist[255 - 4 * lane - j]; s += c[j]; }
            unsigned incl = s;
            for (int o = 1; o < 64; o <<= 1) { const unsigned t = __shfl_up(incl, o); if (lane >= o) incl += t; }
            unsigned before = incl - s;
            if (before < kk && incl >= kk) {
                unsigned acc2 = before;
#pragma unroll
                for (int j = 0; j < 4; ++j) { if (acc2 < kk && acc2 + c[j] >= kk) { sh[0] = prefix | ((unsigned)(255 - 4 * lane - j) << shift); sh[1] = kk - acc2; } acc2 += c[j]; }
            }
        }
        __syncthreads();
    }
    const unsigned T = sh[0], need = sh[1];
    __syncthreads();
    unsigned ceq = 0, cgt = 0;
#pragma unroll
    for (int i = 0; i < 8; ++i) { ceq += (kv[i] == T); cgt += (kv[i] > T); }
    unsigned ieq = ceq, igt = cgt;
    for (int o = 1; o < 64; o <<= 1) { const unsigned t1 = __shfl_up(ieq, o), t2 = __shfl_up(igt, o); if (lane >= o) { ieq += t1; igt += t2; } }
    if (lane == 63) { sh[8 + wid] = ieq; sh[16 + wid] = igt; }
    __syncthreads();
    unsigned beq = ieq - ceq, bgt = igt - cgt;
    for (int w = 0; w < wid; ++w) { beq += sh[8 + w]; bgt += sh[16 + w]; }
    int* selidx = (int*)(F.ws + WS_SELIDX) + unit * CAP; float* selgate = (float*)(F.ws + WS_SELGATE) + (size_t)(e * NB + b) * CAP; int* inv = (int*)(F.ws + WS_INV);
#pragma unroll
    for (int i = 0; i < 8; ++i) {
        const bool gt = kv[i] > T, eq = kv[i] == T; const bool take = gt || (eq && beq < need);
        if (take) { const unsigned slot = bgt + (beq < need ? beq : need); const int n = tid * 8 + i;
            selidx[slot] = n; selgate[slot] = __uint_as_float(kv[i]); inv[(size_t)(b * SEQ + n) * 16 + e] = (int)slot; }
        bgt += gt; beq += eq;
    }
    __syncthreads();
}

__device__ __forceinline__ void phase_gather(const Frame& F) {
    const int* selidx = (const int*)(F.ws + WS_SELIDX); const bf16_t* H = (const bf16_t*)(F.ws + WS_H); bf16_t* XS = (bf16_t*)(F.ws + WS_XS);
    for (int r = F.bid * 8 + F.wave; r < MOE_ROWS; r += F.G * 8) {
        const int e = r >> 11, b = (r >> 9) & 3, slot = r & 511;
        const int n = selidx[(b * 16 + e) * CAP + slot];
        const u32x4* src = (const u32x4*)(H + (size_t)(b * SEQ + n) * DM); u32x4* dst = (u32x4*)(XS + (size_t)r * DM);
#pragma unroll
        for (int i = 0; i < 4; ++i) dst[F.lane + 64 * i] = src[F.lane + 64 * i];
    }
}

__device__ __forceinline__ void phase_final(const Frame& F, const float* ln2_g, const float* ln2_b, float* out) {
    const float* X1 = (const float*)(F.ws + WS_X1); const bf16_t* Y = (const bf16_t*)(F.ws + WS_Y); const int* inv = (const int*)(F.ws + WS_INV);
    const float* mod = (const float*)(F.ws + WS_MOD);
    const int lane = F.lane;
    for (int row = F.bid * 8 + F.wave; row < NLAT; row += F.G * 8) {
        const int b = row >> 12;
        f32x4 f[8];
#pragma unroll
        for (int i = 0; i < 8; ++i) f[i] = (f32x4){0.f, 0.f, 0.f, 0.f};
        for (int e = 0; e < 16; ++e) {
            const int slot = inv[(size_t)row * 16 + e];
            if (slot >= 0) {
                const bf16_t* yr = Y + (size_t)((e * NB + b) * CAP + slot) * DM;
#pragma unroll
                for (int i = 0; i < 8; ++i) { const u32x2 w = *(const u32x2*)(yr + 4 * (lane + 64 * i));
                    f[i][0] += __uint_as_float(w.x << 16); f[i][1] += __uint_as_float(w.x & 0xffff0000u); f[i][2] += __uint_as_float(w.y << 16); f[i][3] += __uint_as_float(w.y & 0xffff0000u); }
            }
        }
        float s = 0.f;
#pragma unroll
        for (int i = 0; i < 8; ++i) { const int d = 4 * (lane + 64 * i);
            const f32x4 xv = *(const f32x4*)(X1 + (size_t)row * DM + d), g2 = *(const f32x4*)(mod + b * 12288 + 5 * DM + d);
            f[i] = xv * ALPHA + g2 * f[i]; s += (f[i][0] + f[i][1]) + (f[i][2] + f[i][3]); }
        const float mu = wave_sum(s) * (1.0f / 2048.0f);
        float q = 0.f;
#pragma unroll
        for (int i = 0; i < 8; ++i) { const f32x4 d = f[i] - mu; q += (d[0] * d[0] + d[1] * d[1]) + (d[2] * d[2] + d[3] * d[3]); }
        const float rstd = rsqrtf(wave_sum(q) * (1.0f / 2048.0f) + 1e-5f);
#pragma unroll
        for (int i = 0; i < 8; ++i) { const int d = 4 * (lane + 64 * i);
            const f32x4 g = *(const f32x4*)(ln2_g + d), bb = *(const f32x4*)(ln2_b + d);
            *(f32x4*)(out + (size_t)row * DM + d) = (f[i] - mu) * rstd * g + bb; }
    }
}

constexpr int N_PHASES = 13;
__global__ void __launch_bounds__(NTHR, 2) mk_fwd(Args args) {
    extern __shared__ __attribute__((aligned(16))) unsigned char lds_raw[];
    Frame F;
    F.lds = (char*)lds_raw; F.ldsL = (LAS unsigned char*)lds_raw; F.tid = threadIdx.x; F.lane = F.tid & 63; F.wave = __builtin_amdgcn_readfirstlane(F.tid >> 6); F.G = gridDim.x; F.bid = blockIdx.x;
    F.ws = args.ws;
    LAS unsigned char* ldsL = (LAS unsigned char*)lds_raw;
    volatile LAS unsigned* misc = (volatile LAS unsigned*)(ldsL + LDS_MISC);
    if (F.tid < 4) misc[F.tid] = 0u;
    __syncthreads();
    const int lo = args.ph_lo, hi = args.ph_hi;
    XcdBarrier bar; bar.bar = (unsigned*)(F.ws + WS_CTL); bar.x = 0; bar.st = misc;
    if (hi - lo > 1) bar = xcd_barrier_post((unsigned*)(F.ws + WS_CTL), misc);
#ifdef ONLY_PHASE
#define IN(k) ((k) == ONLY_PHASE && lo <= (k) && (k) < hi)
#else
#define IN(k) (lo <= (k) && (k) < hi)
#endif
#define SEAM(k) do { if (IN(k) && IN((k) + 1)) xcd_barrier(bar); } while (0)
    const int vcu = (F.G % 8 == 0) ? (F.bid % 8) * (F.G / 8) + F.bid / 8 : F.bid;

    if (IN(0)) { phase_mod(F, args.in[1], args.in[3], args.in[4], args.in[5], args.in[10]); __syncthreads(); phase_convert(F, args.in[6], args.in[12], args.in[16], args.in[17], args.in[18]); }
    SEAM(0);
    if (IN(1)) { phase_u(F, args.in[0], args.in[2]); }
    SEAM(1);
    if (IN(2)) {
        pg8::Gemm g{(const bf16_t*)(F.ws + WS_U), (const bf16_t*)(F.ws + WS_WINT), MROWS, DINP, DM}; pg8::StaticOrder S; S.init(MROWS, DINP, F.G, F.bid);
        pg8::EpiInProj E{(bf16_t*)(F.ws + WS_P), (const float*)(F.ws + WS_ROPE)};
        pg8::gemm_phase<pg8::EpiInProj, pg8::StaticOrder>(ldsL, g, S, E);
    }
    SEAM(2);
    if (IN(3)) { for (int u = F.bid; u < 2 * 16 * NCH; u += F.G) gla_pre_unit(F, u, args.in[7], args.in[8]); }
    SEAM(3);
    if (IN(4)) { for (int u = F.bid; u < 256; u += F.G) gla_scan_unit(F, u); }
    SEAM(4);
    if (IN(5)) {
        phase_gla_combine(F, args.in[9]);
        const float lam = *(const float*)(F.ws + WS_LAM);
        for (int u = vcu; u < 512; u += F.G) att::attn_unit(F, u >> 7, (u >> 4) & 7, u & 15, lam, args.in[11]);
    }
    SEAM(5);
    if (IN(6)) {
        pg8::Gemm g{(const bf16_t*)(F.ws + WS_A2), (const bf16_t*)(F.ws + WS_WOT), NLAT, DM, DM}; pg8::StaticOrder S; S.init(NLAT, DM, F.G, F.bid);
        pg8::EpiOutProj E{(float*)(F.ws + WS_V1), args.in[0], (const float*)(F.ws + WS_MOD)};
        pg8::gemm_phase<pg8::EpiOutProj, pg8::StaticOrder>(ldsL, g, S, E);
    }
    SEAM(6);
    if (IN(7)) { phase_ln1(F, args.in[15], args.in[13], args.in[14]); }
    SEAM(7);
    if (IN(8)) { for (int u = F.bid; u < 64; u += F.G) topk_unit(F, u); }
    SEAM(8);
    if (IN(9)) { phase_gather(F); }
    SEAM(9);
    if (IN(10)) {
        pg8::Gemm g{(const bf16_t*)(F.ws + WS_XS), (const bf16_t*)(F.ws + WS_W13T), MOE_ROWS, 4096, DM}; pg8::MoeOrder S; S.init(MOE_ROWS, 4096, F.G, F.bid);
        pg8::EpiMoeUp E{(bf16_t*)(F.ws + WS_HID)};
        pg8::gemm_phase<pg8::EpiMoeUp, pg8::MoeOrder>(ldsL, g, S, E);
    }
    SEAM(10);
    if (IN(11)) {
        pg8::Gemm g{(const bf16_t*)(F.ws + WS_HID), (const bf16_t*)(F.ws + WS_W2T), MOE_ROWS, 2048, DM}; pg8::MoeOrder S; S.init(MOE_ROWS, 2048, F.G, F.bid);
        pg8::EpiMoeDown E{(bf16_t*)(F.ws + WS_Y), (const float*)(F.ws + WS_SELGATE)};
        pg8::gemm_phase<pg8::EpiMoeDown, pg8::MoeOrder>(ldsL, g, S, E);
    }
    SEAM(11);
    if (IN(12)) { phase_final(F, args.in[19], args.in[20], args.out); }
#undef IN
#undef SEAM
}

extern "C" void kernel_launch(void* const* d_in, const int* in_sizes, int n_in, void* d_out, int out_size, void* d_ws, size_t ws_size, hipStream_t stream) {
    static int grid = 0;
    if (grid == 0) {
        if (n_in != 21 || out_size != NLAT * DM || ws_size < WS_END) { fprintf(stderr, "kernel_launch: unexpected shapes: n_in %d out %d ws %zu (need %zu)\n", n_in, out_size, ws_size, (size_t)WS_END); grid = -1; return; }
        int dev = 0, cus = 0, per_cu = 0;
        if (hipGetDevice(&dev) != hipSuccess || hipDeviceGetAttribute(&cus, hipDeviceAttributeMultiprocessorCount, dev) != hipSuccess) { grid = -1; return; }
        if (hipFuncSetAttribute((const void*)mk_fwd, hipFuncAttributeMaxDynamicSharedMemorySize, LDS_BYTES) != hipSuccess) { fprintf(stderr, "kernel_launch: hipFuncSetAttribute failed\n"); grid = -1; return; }
        if (hipOccupancyMaxActiveBlocksPerMultiprocessor(&per_cu, (const void*)mk_fwd, NTHR, LDS_BYTES) != hipSuccess || per_cu < 1) { fprintf(stderr, "kernel_launch: occupancy query says %d\n", per_cu); }
        (void)hipGetLastError();
        grid = cus;
    }
    if (grid < 0) return;
    (void)hipMemsetAsync((char*)d_ws + WS_CTL, 0, CTL_BYTES, stream);
    Args a{};
    for (int i = 0; i < 21; ++i) a.in[i] = (const float*)d_in[i];
    a.out = (float*)d_out; a.ws = (unsigned char*)d_ws;
#if MK_ONE_LAUNCH
    a.ph_lo = 0; a.ph_hi = N_PHASES;
    hipLaunchKernelGGL(mk_fwd, dim3(grid), dim3(NTHR), LDS_BYTES, stream, a);
#else
    for (int p = 0; p < N_PHASES; ++p) { a.ph_lo = p; a.ph_hi = p + 1; hipLaunchKernelGGL(mk_fwd, dim3(grid), dim3(NTHR), LDS_BYTES, stream, a); }
#endif
    const hipError_t le = hipPeekAtLastError();
    if (le != hipSuccess) fprintf(stderr, "kernel_launch: launch failed: %s\n", hipGetErrorName(le));
}
```
